# Optimizing an MI355X kernel written in HIP

```python
import jax, jax.numpy as jnp
from jax import lax
import numpy as np

D_MODEL = 1024
BATCH = 2
SEQ = 8192
DEPTH = 1
DEC_BATCH = 128
DEC_SEQ = 4
PAST_LEN = 8192
PAGE_SIZE = 128

N_META = 16
D_MLSTM = D_MODEL // 2
D_SWA = D_MODEL - D_MLSTM
M_HEADS = 4
M_DH = D_MLSTM // M_HEADS
A_HEADS = 8
A_KV_HEADS = 2
A_GROUP = A_HEADS // A_KV_HEADS
A_DH = D_SWA // A_HEADS
KV_W = A_KV_HEADS * A_DH
WINDOW = 128
CHUNK = 128
LN_EPS = 1e-5
DN_ALPHA = (2.0 * DEPTH) ** 0.25
DN_BETA = (8.0 * DEPTH) ** -0.25
PROJ_SIZES = (D_MLSTM, D_MLSTM, D_MLSTM, D_MLSTM, D_MLSTM, M_HEADS, M_HEADS, D_SWA, KV_W, KV_W, D_SWA)
N_IN = sum(PROJ_SIZES)
F_GATE_OFF = 5 * D_MLSTM + M_HEADS

kernel_name = "hymba_mlstm_swa_sink_decode_step"


def layer_norm(x, g, b):
    xf = x.astype(jnp.float32)
    mu = jnp.mean(xf, -1, keepdims=True)
    var = jnp.mean(jnp.square(xf - mu), -1, keepdims=True)
    y = (xf - mu) * lax.rsqrt(var + LN_EPS) * g.astype(jnp.float32) + b.astype(jnp.float32)
    return y.astype(x.dtype)


def split_proj(u):
    parts, off = [], 0
    for n in PROJ_SIZES:
        parts.append(u[..., off:off + n])
        off += n
    return parts


def mlstm_inputs(mq, mk, mv, mi, mf):
    f32 = jnp.float32
    shp = mq.shape[:2] + (M_HEADS, M_DH)
    q = mq.astype(f32).reshape(shp)
    k = mk.astype(f32).reshape(shp) * (M_DH ** -0.5)
    v = mv.astype(f32).reshape(shp)
    log_i = mi.astype(f32)
    log_f = jax.nn.log_sigmoid(mf.astype(f32))
    return q, k, v, log_i, log_f


def mlstm_chunk(state, q, k, v, log_i, log_f):
    c, n, m = state
    L = q.shape[1]
    b = jnp.cumsum(log_f, axis=1)
    dmat = b[:, :, None, :] - b[:, None, :, :] + log_i[:, None, :, :]
    causal = jnp.tril(jnp.ones((L, L), bool))[:, :, None]
    dmat = jnp.where(causal, dmat, -jnp.inf)
    inter = b + m[:, None, :]
    m_t = jnp.maximum(inter, jnp.max(dmat, axis=2))
    w = jnp.exp(dmat - m_t[:, :, None, :])
    s_inter = jnp.exp(inter - m_t)
    qk = jnp.einsum('bthd,bshd->btsh', q, k) * w
    num = jnp.einsum('btsh,bshd->bthd', qk, v) + jnp.einsum('bthk,bhkv->bthv', q, c) * s_inter[..., None]
    den = jnp.sum(qk, axis=2) + jnp.einsum('bthk,bhk->bth', q, n) * s_inter
    h = num / jnp.maximum(jnp.abs(den), jnp.exp(-m_t))[..., None]
    b_last = b[:, -1]
    m_new = m_t[:, -1]
    w_state = jnp.exp(b_last[:, None, :] - b + log_i - m_new[:, None, :])
    decay = jnp.exp(b_last + m - m_new)
    c_new = decay[..., None, None] * c + jnp.einsum('bsh,bshk,bshv->bhkv', w_state, k, v)
    n_new = decay[..., None] * n + jnp.einsum('bsh,bshk->bhk', w_state, k)
    return (c_new, n_new, m_new), h


def mlstm_prompt(q, k, v, log_i, log_f):
    f32 = jnp.float32
    B, T = q.shape[:2]
    n_chunks = (T - N_META) // CHUNK
    st = (jnp.zeros((B, M_HEADS, M_DH, M_DH), f32), jnp.zeros((B, M_HEADS, M_DH), f32),
          jnp.zeros((B, M_HEADS), f32))
    st, h_meta = mlstm_chunk(st, q[:, :N_META], k[:, :N_META], v[:, :N_META],
                             log_i[:, :N_META], log_f[:, :N_META])

    def to_chunks(a):
        a = a[:, N_META:]
        return jnp.swapaxes(a.reshape((B, n_chunks, CHUNK) + a.shape[2:]), 0, 1)

    def body(carry, xs):
        return mlstm_chunk(carry, *xs)

    st, h_real = lax.scan(body, st, tuple(to_chunks(a) for a in (q, k, v, log_i, log_f)))
    h_real = jnp.swapaxes(h_real, 0, 1).reshape(B, T - N_META, M_HEADS, M_DH)
    return jnp.concatenate([h_meta, h_real], axis=1), st


def swa_inputs(aq, ak, av):
    f32 = jnp.float32
    B, T = aq.shape[:2]
    q = aq.astype(f32).reshape(B, T, A_KV_HEADS, A_GROUP, A_DH)
    k = ak.astype(f32).reshape(B, T, A_KV_HEADS, A_DH)
    v = av.astype(f32).reshape(B, T, A_KV_HEADS, A_DH)
    return q, k, v


def sink_softmax(s, sink):
    sk = sink.astype(jnp.float32)[:, :, None, None]
    mx = jnp.maximum(jnp.max(s, axis=-1, keepdims=True), sk)
    p = jnp.exp(s - mx)
    return p / (jnp.sum(p, axis=-1, keepdims=True) + jnp.exp(sk - mx))


def swa_prompt(q, k, v, sink):
    B, T = q.shape[:2]
    n_real = T - N_META
    nb = n_real // WINDOW
    q = q * (A_DH ** -0.5)
    qm, km, vm = q[:, :N_META], k[:, :N_META], v[:, :N_META]
    s = jnp.einsum('bqkgd,bskd->bkgqs', qm, km)
    s = jnp.where(jnp.tril(jnp.ones((N_META, N_META), bool)), s, -jnp.inf)
    o_meta = jnp.einsum('bkgqs,bskd->bqkgd', sink_softmax(s, sink), vm)
    qb = q[:, N_META:].reshape(B, nb, WINDOW, A_KV_HEADS, A_GROUP, A_DH)
    kb = k[:, N_META:].reshape(B, nb, WINDOW, A_KV_HEADS, A_DH)
    vb = v[:, N_META:].reshape(B, nb, WINDOW, A_KV_HEADS, A_DH)
    pad = ((0, 0), (1, 0), (0, 0), (0, 0), (0, 0))
    kprev = jnp.pad(kb, pad)[:, :-1]
    vprev = jnp.pad(vb, pad)[:, :-1]
    kmeta = jnp.broadcast_to(km[:, None], (B, nb, N_META, A_KV_HEADS, A_DH))
    vmeta = jnp.broadcast_to(vm[:, None], (B, nb, N_META, A_KV_HEADS, A_DH))
    kcat = jnp.concatenate([kmeta, kprev, kb], axis=2)
    vcat = jnp.concatenate([vmeta, vprev, vb], axis=2)
    diff = jnp.arange(WINDOW)[:, None] - (jnp.arange(2 * WINDOW)[None, :] - WINDOW)
    band = (diff >= 0) & (diff < WINDOW)
    has_prev = (jnp.arange(nb) > 0)[:, None, None]
    prev_col = (jnp.arange(2 * WINDOW) < WINDOW)[None, None, :]
    band_b = band[None] & (has_prev | ~prev_col)
    mask = jnp.concatenate([jnp.ones((nb, WINDOW, N_META), bool), band_b], axis=-1)
    s = jnp.einsum('bnqkgd,bnskd->bnkgqs', qb, kcat)
    s = jnp.where(mask[None, :, None, None], s, -jnp.inf)
    o_real = jnp.einsum('bnkgqs,bnskd->bnqkgd', sink_softmax(s, sink), vcat)
    o_real = o_real.reshape(B, n_real, A_KV_HEADS, A_GROUP, A_DH)
    return jnp.concatenate([o_meta, o_real], axis=1)


def swa_sample(q, k, v, ck, cv, sink):
    f32 = jnp.float32
    L = q.shape[1]
    kk = jnp.concatenate([ck.astype(f32), k], axis=1)
    vv = jnp.concatenate([cv.astype(f32), v], axis=1)
    qpos = PAST_LEN + jnp.arange(L)
    buf_pos = PAST_LEN - WINDOW + jnp.arange(WINDOW)
    meta_ok = jnp.ones((L, N_META), bool)
    win_ok = ((qpos[:, None] - buf_pos[None, :]) < WINDOW) & (buf_pos[None, :] >= N_META)
    dnew = jnp.arange(L)[:, None] - jnp.arange(L)[None, :]
    new_ok = (dnew >= 0) & (dnew < WINDOW)
    mask = jnp.concatenate([meta_ok, win_ok, new_ok], axis=1)
    s = jnp.einsum('bqkgd,bskd->bkgqs', q * (A_DH ** -0.5), kk)
    s = jnp.where(mask, s, -jnp.inf)
    o = jnp.einsum('bkgqs,bskd->bqkgd', sink_softmax(s, sink), vv)
    new_k = jnp.concatenate([ck[:, :N_META],
                             jnp.concatenate([ck[:, N_META:], k.astype(ck.dtype)], axis=1)[:, -WINDOW:]], axis=1)
    new_v = jnp.concatenate([cv[:, :N_META],
                             jnp.concatenate([cv[:, N_META:], v.astype(cv.dtype)], axis=1)[:, -WINDOW:]], axis=1)
    return o, new_k, new_v


def mix_and_residual(x, h_m, o_pre, z_m, h_a, z_a, norm_g, w_o, g, b):
    f32 = jnp.float32
    B, T = x.shape[:2]
    h_m = h_m * jax.nn.sigmoid(o_pre.astype(f32)).reshape(h_m.shape)
    mu = jnp.mean(h_m, -1, keepdims=True)
    var = jnp.mean(jnp.square(h_m - mu), -1, keepdims=True)
    h_m = ((h_m - mu) * lax.rsqrt(var + LN_EPS)).reshape(B, T, D_MLSTM) * norm_g.astype(f32)
    y_m = h_m * jax.nn.silu(z_m.astype(f32))
    y_a = h_a.reshape(B, T, D_SWA) * jax.nn.silu(z_a.astype(f32))
    mix = jnp.concatenate([y_m, y_a], axis=-1).astype(w_o.dtype) @ w_o
    return layer_norm(DN_ALPHA * x + mix.astype(x.dtype), g, b)


def setup_inputs(seed: int = 0) -> dict:
    key = jax.random.key(seed)
    ks = jax.random.split(key, 18)
    f32 = jnp.float32

    def nrm(k, shape, scale=1.0):
        return scale * jax.random.normal(k, shape, f32)

    buf = (DEPTH, DEC_BATCH, N_META + WINDOW, A_KV_HEADS, A_DH)
    b_in = nrm(ks[10], (DEPTH, N_IN), 0.02)
    b_in = b_in.at[:, F_GATE_OFF:F_GATE_OFF + M_HEADS].add(jnp.linspace(3.0, 6.0, M_HEADS, dtype=f32))
    return {
        "x_prompt": nrm(ks[0], (BATCH, SEQ, D_MODEL)),
        "x_sample": nrm(ks[1], (DEC_BATCH, DEC_SEQ, D_MODEL)),
        "cache_swa_k": nrm(ks[2], buf),
        "cache_swa_v": nrm(ks[3], buf),
        "state_mlstm_c": nrm(ks[4], (DEPTH, DEC_BATCH, M_HEADS, M_DH, M_DH), 0.3),
        "state_mlstm_n": nrm(ks[5], (DEPTH, DEC_BATCH, M_HEADS, M_DH), 0.3),
        "state_mlstm_m": nrm(ks[6], (DEPTH, DEC_BATCH, M_HEADS), 0.5),
        "meta_tokens": nrm(ks[7], (N_META, D_MODEL)),
        "ln0_g": 1.0 + nrm(ks[8], (D_MODEL,), 0.02),
        "ln0_b": nrm(ks[9], (D_MODEL,), 0.02),
        "w_in": nrm(ks[11], (DEPTH, D_MODEL, N_IN), D_MODEL ** -0.5),
        "b_in": b_in,
        "a_sinks": nrm(ks[12], (DEPTH, A_HEADS), 0.5),
        "m_norm_g": 1.0 + nrm(ks[13], (DEPTH, D_MLSTM), 0.02),
        "w_out": nrm(ks[14], (DEPTH, D_MODEL, D_MODEL), DN_BETA * D_MODEL ** -0.5),
        "ln_g": 1.0 + nrm(ks[15], (DEPTH, D_MODEL), 0.02),
        "ln_b": nrm(ks[16], (DEPTH, D_MODEL), 0.02),
    }


def reference(x_prompt, x_sample, cache_swa_k, cache_swa_v, state_mlstm_c, state_mlstm_n, state_mlstm_m,
              meta_tokens, ln0_g, ln0_b, w_in, b_in, a_sinks, m_norm_g, w_out, ln_g, ln_b):
    f32 = jnp.float32
    B = x_prompt.shape[0]
    meta = jnp.broadcast_to(meta_tokens.astype(x_prompt.dtype)[None], (B, N_META, D_MODEL))
    hp = layer_norm(jnp.concatenate([meta, x_prompt], axis=1), ln0_g, ln0_b)
    hs = layer_norm(x_sample, ln0_g, ln0_b)
    pk, pv, pc, pn, pm = [], [], [], [], []
    sk, sv, sc, sn, sm = [], [], [], [], []
    for l in range(DEPTH):
        sink = a_sinks[l].reshape(A_KV_HEADS, A_GROUP)
        mq, mk, mv, mo, mz, mi, mf, aq, ak, av, az = split_proj(hp @ w_in[l] + b_in[l])
        h_m, (c1, n1, m1) = mlstm_prompt(*mlstm_inputs(mq, mk, mv, mi, mf))
        q_a, k_a, v_a = swa_inputs(aq, ak, av)
        h_a = swa_prompt(q_a, k_a, v_a, sink)
        pk.append(jnp.concatenate([k_a[:, :N_META], k_a[:, -WINDOW:]], axis=1).astype(cache_swa_k.dtype))
        pv.append(jnp.concatenate([v_a[:, :N_META], v_a[:, -WINDOW:]], axis=1).astype(cache_swa_v.dtype))
        pc.append(c1.astype(state_mlstm_c.dtype))
        pn.append(n1.astype(state_mlstm_n.dtype))
        pm.append(m1.astype(state_mlstm_m.dtype))
        hp = mix_and_residual(hp, h_m, mo, mz, h_a, az, m_norm_g[l], w_out[l], ln_g[l], ln_b[l])
        mq, mk, mv, mo, mz, mi, mf, aq, ak, av, az = split_proj(hs @ w_in[l] + b_in[l])
        st0 = (state_mlstm_c[l].astype(f32), state_mlstm_n[l].astype(f32), state_mlstm_m[l].astype(f32))
        (c2, n2, m2), h_m = mlstm_chunk(st0, *mlstm_inputs(mq, mk, mv, mi, mf))
        q_a, k_a, v_a = swa_inputs(aq, ak, av)
        h_a, nk, nv = swa_sample(q_a, k_a, v_a, cache_swa_k[l], cache_swa_v[l], sink)
        sk.append(nk)
        sv.append(nv)
        sc.append(c2.astype(state_mlstm_c.dtype))
        sn.append(n2.astype(state_mlstm_n.dtype))
        sm.append(m2.astype(state_mlstm_m.dtype))
        hs = mix_and_residual(hs, h_m, mo, mz, h_a, az, m_norm_g[l], w_out[l], ln_g[l], ln_b[l])
    y_prompt = hp[:, N_META:]
    y_sample = hs
    return (y_prompt, y_sample,
            jnp.stack(pk), jnp.stack(pv), jnp.stack(pc), jnp.stack(pn), jnp.stack(pm),
            jnp.stack(sk), jnp.stack(sv), jnp.stack(sc), jnp.stack(sn), jnp.stack(sm))
```

```cpp
#include <hip/hip_runtime.h>
#include <cstdio>
#include <cstdint>
namespace pg8 {
#define PG8_LAS __attribute__((address_space(3)))
typedef unsigned short bf16_t;
typedef short bf16x8 __attribute__((ext_vector_type(8)));
typedef float f32x4 __attribute__((ext_vector_type(4)));
typedef unsigned u32x4 __attribute__((ext_vector_type(4)));
constexpr int BM = 256, BK = 64, HALF = 128, HTB = HALF * BK * 2  , STAGE_BYTES = 8 * HTB, NXCD = 8, WGM = 8;

__host__ __device__ __forceinline__ int lds_byte(int r, int c) { const int st = (r >> 4) * 2 + (c >> 5), rr = r & 15, cc = c & 31, ob = rr * 64 + cc * 2; return st * 1024 + (ob ^ (((ob >> 9) & 1) << 5)); }
__host__ __device__ __forceinline__ void stage_rc(int b, int& R, int& C) { const int st = b / 1024, sb = b % 1024, swz = sb ^ (((sb >> 9) & 1) << 5); R = (st >> 1) * 16 + swz / 64; C = (st & 1) * 32 + (swz % 64) / 2; }
__host__ __device__ __forceinline__ int perm32(int rho) { const int n = rho >> 4, i = rho & 15; return 8 * (i >> 2) + 4 * n + (i & 3); }

struct Unit { int pm, pn; };
struct Gemm { const bf16_t* A; const bf16_t* Bt; int M, N, K; };

struct StaticOrder {
    int nM, nN, nwg, G, c;
    __host__ __device__ void init(int M, int N, int G_, int c_) { nM = M / BM; nN = N / BM; nwg = nM * nN; G = G_; c = c_; }
    __host__ __device__ bool next(int i, Unit& u) const {
        const long L = (long)i * G + c; if (L >= nwg) return false;
        int wgid = (int)L; { const int q = nwg / NXCD, r = nwg % NXCD, xcd = wgid % NXCD, off = wgid / NXCD; wgid = (xcd < r ? xcd * (q + 1) : r * (q + 1) + (xcd - r) * q) + off; }
        const int nig = WGM * nN, gid = wgid / nig, fm = gid * WGM, gsz = (nM - fm) < WGM ? (nM - fm) : WGM;
        u.pm = fm + ((wgid % nig) % gsz); u.pn = (wgid % nig) / gsz; return true;
    }
    __device__ __forceinline__ void a_ready(const Unit&) const {}
    __device__ __forceinline__ void done(const Unit&) const {}
};

__device__ __forceinline__ unsigned cvt_pk_bf16(float lo, float hi) { unsigned r; asm volatile("v_cvt_pk_bf16_f32 %0, %1, %2" : "=v"(r) : "v"(lo), "v"(hi)); return r; }
struct PanelStats {
    unsigned* xbuf;
    unsigned* cnt;
    unsigned* tmo;
    int ntn; float eps;
    unsigned code;
    __device__ __forceinline__ bool run(const f32x4 (&v)[2][2][4][2], const Unit& u, int wr, int wc, int fr, int fq, PG8_LAS unsigned char* lds, int wid, int lane) const {
        typedef float f32x2v __attribute__((ext_vector_type(2)));
        PG8_LAS f32x2v* P = (PG8_LAS f32x2v*)lds;
        PG8_LAS f32x2v* S = (PG8_LAS f32x2v*)(lds + 8192);
        PG8_LAS unsigned* flag = (PG8_LAS unsigned*)(lds + 8192 + 2048);
#pragma unroll
        for (int ai = 0; ai < 2; ++ai)
#pragma unroll
            for (int m = 0; m < 4; ++m) {
                float s = 0.f;
#pragma unroll
                for (int bj = 0; bj < 2; ++bj)
#pragma unroll
                    for (int n = 0; n < 2; ++n) { const f32x4 x = v[ai][bj][m][n]; s += (x[0] + x[1]) + (x[2] + x[3]); }
                s += __shfl_xor(s, 16); s += __shfl_xor(s, 32);
                const float mw = s * (1.0f / 64.0f); float q = 0.f;
#pragma unroll
                for (int bj = 0; bj < 2; ++bj)
#pragma unroll
                    for (int n = 0; n < 2; ++n) { const f32x4 d = v[ai][bj][m][n] - mw; q += (d[0] * d[0] + d[1] * d[1]) + (d[2] * d[2] + d[3] * d[3]); }
                q += __shfl_xor(q, 16); q += __shfl_xor(q, 32);
                if (fq == 0) P[(ai * HALF + wr * 64 + m * 16 + fr) * 4 + wc] = (f32x2v){mw, q};
            }
        asm volatile("s_waitcnt lgkmcnt(0)" ::: "memory"); __builtin_amdgcn_s_barrier(); asm volatile("" ::: "memory");
#if defined(BROKEN_EXCHANGE_NO_WAIT)
#warning BROKEN CONTROL BUILD: the row-statistics exchange does not wait; results are wrong by design
        if (blockIdx.x >= 64) { const long long t0_ = clock64(); while (clock64() - t0_ < 60000) __builtin_amdgcn_s_sleep(8); }
#endif
        const int row = wid * 32 + (lane & 31);
        if (lane < 32) {
            const f32x2v a = P[row * 4 + 0], b = P[row * 4 + 1], c = P[row * 4 + 2], d = P[row * 4 + 3];
            const float mt = (a.x + b.x + c.x + d.x) * 0.25f;
            const float da = a.x - mt, db = b.x - mt, dc = c.x - mt, dd = d.x - mt;
            const float m2 = (a.y + b.y) + (c.y + d.y) + 64.0f * ((da * da + db * db) + (dc * dc + dd * dd));
            unsigned long long* slot = (unsigned long long*)xbuf + ((size_t)(u.pm * BM + row) * 4 + u.pn);
            __hip_atomic_store(slot, ((unsigned long long)__float_as_uint(m2) << 32) | __float_as_uint(mt), __ATOMIC_RELAXED, __HIP_MEMORY_SCOPE_AGENT);
        }
        asm volatile("s_waitcnt vmcnt(0)" ::: "memory");
        if (lane == 0) __hip_atomic_fetch_add(cnt + 64 * u.pm, 1u, __ATOMIC_RELAXED, __HIP_MEMORY_SCOPE_AGENT);
        if (wid == 0) {
            bool dead = false; const unsigned long long t0 = __builtin_amdgcn_s_memrealtime(); const unsigned want = 8u * (unsigned)ntn;
            for (;;) {
#if defined(BROKEN_EXCHANGE_NO_WAIT)
                break;
#endif
                if ((unsigned)__builtin_amdgcn_readfirstlane(__hip_atomic_load(cnt + 64 * u.pm, __ATOMIC_RELAXED, __HIP_MEMORY_SCOPE_AGENT)) >= want) break;
                if (__builtin_amdgcn_s_memrealtime() - t0 > 2000000ull) {
                    if (lane == 0) { unsigned expect = 0u; __hip_atomic_compare_exchange_strong(tmo + 1, &expect, code | (unsigned)(u.pm & 0xff), __ATOMIC_RELAXED, __ATOMIC_RELAXED, __HIP_MEMORY_SCOPE_AGENT);
                                     __hip_atomic_store(tmo, 1u, __ATOMIC_RELAXED, __HIP_MEMORY_SCOPE_AGENT); }
                    dead = true; break; }
                __builtin_amdgcn_s_sleep(2);
            }
            __builtin_amdgcn_fence(__ATOMIC_ACQUIRE, "agent");
            if (lane == 0) flag[0] = dead ? 1u : 0u;
        }
        asm volatile("s_waitcnt vmcnt(0) lgkmcnt(0)" ::: "memory"); __builtin_amdgcn_s_barrier(); asm volatile("" ::: "memory");
        const bool bad = flag[0] != 0u;
        if (lane < 32) {
            const unsigned long long* slot = (const unsigned long long*)xbuf + (size_t)(u.pm * BM + row) * 4; float mt[4], m2[4]; float ms = 0.f;
#pragma unroll
            for (int t = 0; t < 4; ++t) { if (t < ntn) { const unsigned long long w = __hip_atomic_load(slot + t, __ATOMIC_RELAXED, __HIP_MEMORY_SCOPE_AGENT); mt[t] = __uint_as_float((unsigned)w); m2[t] = __uint_as_float((unsigned)(w >> 32)); } else { mt[t] = 0.f; m2[t] = 0.f; } ms += mt[t]; }
            const float mean = ms / (float)ntn; float q = 0.f;
#pragma unroll
            for (int t = 0; t < 4; ++t) if (t < ntn) { const float dm = mt[t] - mean; q += m2[t] + 256.0f * dm * dm; }
            S[row] = (f32x2v){mean, 1.0f / sqrtf(q / (256.0f * (float)ntn) + eps)};
        }
        asm volatile("s_waitcnt lgkmcnt(0)" ::: "memory"); __builtin_amdgcn_s_barrier(); asm volatile("" ::: "memory");
        return bad;
    }
};
template <class Epi, class Sched, bool ALIGN_EPI = false, bool SP2 = false>
__device__ __forceinline__ void gemm_phase(PG8_LAS unsigned char* lds, const Gemm g, const Sched& S, const Epi& E) {
    const int tid = threadIdx.x, wid = __builtin_amdgcn_readfirstlane(tid >> 6), lane = tid & 63, wr = wid >> 2, wc = wid & 3, fr = lane & 15, fq = lane >> 4;
    const int K = g.K, nt = K / BK;
    unsigned voffA[2], voffB[2];
#pragma unroll
    for (int i = 0; i < 2; ++i) { int R, C; stage_rc(tid * 16 + i * 8192, R, C); const int Rb = Epi::PERM ? ((R & ~31) + perm32(R & 31)) : R;
        voffA[i] = (unsigned)(R * K + C) * 2u; voffB[i] = (unsigned)(Rb * K + C) * 2u; }
    const size_t kstep = (size_t)(BK * 2);
    const size_t hstep = (size_t)HALF * K * 2;
    const size_t tstep = 2 * hstep;
    const unsigned ldsw = (unsigned)wid * 1024u;
    const int aoff = lds_byte(wr * 64 + fr, fq * 8), boff = lds_byte(wc * 32 + fr, fq * 8);
#define PG8_SA(b, h) (((b) * 2 + (h)) * HTB)
#define PG8_SB(b, h) ((4 + (b) * 2 + (h)) * HTB)
#define PG8_STAGE(bufoff, gbase, voff) do { _Pragma("unroll") for (int _i = 0; _i < 2; ++_i) \
        __builtin_amdgcn_global_load_lds((const unsigned*)((const char*)(gbase) + (voff)[_i]), (PG8_LAS unsigned*)(lds + (bufoff) + ldsw + _i * 8192), 16, 0, 0); } while (0)
#define PG8_LDA(dst, b, h) do { _Pragma("unroll") for (int m = 0; m < 4; ++m) _Pragma("unroll") for (int k = 0; k < 2; ++k) dst[m][k] = *(const PG8_LAS bf16x8*)(lds + PG8_SA(b, h) + aoff + m * 2048 + k * 1024); } while (0)
#define PG8_LDB(dst, b, h) do { _Pragma("unroll") for (int n = 0; n < 2; ++n) _Pragma("unroll") for (int k = 0; k < 2; ++k) dst[n][k] = *(const PG8_LAS bf16x8*)(lds + PG8_SB(b, h) + boff + n * 2048 + k * 1024); } while (0)
#define PG8_MMA(ai, bj, At, Bt) do { __builtin_amdgcn_s_setprio(1); _Pragma("unroll") for (int m = 0; m < 4; ++m) _Pragma("unroll") for (int n = 0; n < 2; ++n) _Pragma("unroll") for (int k = 0; k < 2; ++k) \
        acc[ai][bj][m][n] = __builtin_amdgcn_mfma_f32_16x16x32_bf16(Bt[n][k], At[m][k], acc[ai][bj][m][n], 0, 0, 0); __builtin_amdgcn_s_setprio(0); } while (0)
#define PG8_WAIT_V(n) asm volatile("s_waitcnt vmcnt(" #n ")" ::: "memory")
#define PG8_WAIT_L(n) asm volatile("s_waitcnt lgkmcnt(" #n ")" ::: "memory")
#define PG8_BAR __builtin_amdgcn_s_barrier()
#define PG8_SCHED __builtin_amdgcn_sched_barrier(0)
    Unit cur, nxt; int ui = 0;
    if (!S.next(0, cur)) return;
    f32x4 acc[2][2][4][2];
#pragma unroll
    for (int a = 0; a < 2; ++a)
#pragma unroll
        for (int b = 0; b < 2; ++b)
#pragma unroll
            for (int m = 0; m < 4; ++m)
#pragma unroll
                for (int n = 0; n < 2; ++n) acc[a][b][m][n] = (f32x4){0.f, 0.f, 0.f, 0.f};
    bf16x8 At[4][2], B0[2][2], B1[2][2];
    const char* cA = (const char*)g.A + (size_t)cur.pm * tstep; const char* cB = (const char*)g.Bt + (size_t)cur.pn * tstep;
    S.a_ready(cur);
    if constexpr (SP2) {
        PG8_STAGE(PG8_SB(0, 0), cB, voffB); PG8_STAGE(PG8_SB(0, 1), cB + hstep, voffB); PG8_STAGE(PG8_SA(0, 0), cA, voffA); PG8_STAGE(PG8_SA(0, 1), cA + hstep, voffA);
        if (wr == 1) PG8_BAR;
        PG8_WAIT_V(2); PG8_BAR;
        PG8_STAGE(PG8_SB(1, 0), cB + kstep, voffB); PG8_STAGE(PG8_SA(1, 0), cA + kstep, voffA); PG8_STAGE(PG8_SB(1, 1), cB + hstep + kstep, voffB);
        PG8_WAIT_V(6); PG8_BAR;
    } else {
        PG8_STAGE(PG8_SB(0, 0), cB, voffB); PG8_STAGE(PG8_SA(0, 0), cA, voffA); PG8_STAGE(PG8_SB(0, 1), cB + hstep, voffB); PG8_STAGE(PG8_SA(0, 1), cA + hstep, voffA);
        if (wr == 1) PG8_BAR;
        PG8_WAIT_V(4); PG8_BAR;
        PG8_STAGE(PG8_SB(1, 0), cB + kstep, voffB); PG8_STAGE(PG8_SA(1, 0), cA + kstep, voffA); PG8_STAGE(PG8_SB(1, 1), cB + hstep + kstep, voffB);
        PG8_WAIT_V(6); PG8_BAR;
    }
    for (;;) {
        const bool has_next = S.next(ui + 1, nxt);
        const char* nA = has_next ? (const char*)g.A + (size_t)nxt.pm * tstep : cA; const char* nB = has_next ? (const char*)g.Bt + (size_t)nxt.pn * tstep : cB;
        for (int t = 0; t < nt; t += 2) {
            const bool last = (t == nt - 2);
            const char* a1 = cA + (size_t)(t + 1) * kstep;
            const char* a2 = last ? nA : cA + (size_t)(t + 2) * kstep; const char* b2 = last ? nB : cB + (size_t)(t + 2) * kstep;
            const char* a3 = a2 + kstep; const char* b3 = b2 + kstep;
            if (last && has_next) S.a_ready(nxt);
            if constexpr (SP2) {
            PG8_LDB(B0, 0, 0); PG8_LDB(B1, 0, 1); PG8_SCHED; PG8_LDA(At, 0, 0); PG8_STAGE(PG8_SA(1, 1), a1 + hstep, voffA);
            PG8_WAIT_V(8); PG8_WAIT_L(0); PG8_BAR; PG8_MMA(0, 0, At, B0); PG8_MMA(0, 1, At, B1); PG8_BAR; PG8_SCHED;
            PG8_LDA(At, 0, 1); PG8_STAGE(PG8_SB(0, 0), b2, voffB); PG8_STAGE(PG8_SB(0, 1), b2 + hstep, voffB); PG8_STAGE(PG8_SA(0, 0), a2, voffA);
            PG8_WAIT_V(8); PG8_WAIT_L(0); PG8_BAR; PG8_MMA(1, 0, At, B0); PG8_MMA(1, 1, At, B1); PG8_BAR; PG8_SCHED;
            PG8_LDB(B0, 1, 0); PG8_LDB(B1, 1, 1); PG8_SCHED; PG8_LDA(At, 1, 0); PG8_STAGE(PG8_SA(0, 1), a2 + hstep, voffA);
            PG8_WAIT_V(8); PG8_WAIT_L(0); PG8_BAR; PG8_MMA(0, 0, At, B0); PG8_MMA(0, 1, At, B1); PG8_BAR; PG8_SCHED;
            PG8_LDA(At, 1, 1); PG8_STAGE(PG8_SB(1, 0), b3, voffB); PG8_STAGE(PG8_SB(1, 1), b3 + hstep, voffB); PG8_STAGE(PG8_SA(1, 0), a3, voffA);
            PG8_WAIT_V(8); PG8_WAIT_L(0); PG8_BAR; PG8_MMA(1, 0, At, B0); PG8_MMA(1, 1, At, B1); PG8_BAR; PG8_SCHED;
            } else {
            PG8_LDB(B0, 0, 0); PG8_SCHED; PG8_LDA(At, 0, 0); PG8_STAGE(PG8_SA(1, 1), a1 + hstep, voffA);
            PG8_WAIT_L(8); PG8_BAR; PG8_WAIT_L(0); PG8_MMA(0, 0, At, B0); PG8_BAR; PG8_SCHED;
            PG8_LDB(B1, 0, 1); PG8_STAGE(PG8_SB(0, 0), b2, voffB);
            PG8_BAR; PG8_WAIT_L(0); PG8_MMA(0, 1, At, B1); PG8_BAR;
            PG8_LDA(At, 0, 1); PG8_STAGE(PG8_SA(0, 0), a2, voffA);
            PG8_BAR; PG8_WAIT_L(0); PG8_MMA(1, 0, At, B0); PG8_BAR; PG8_SCHED;
            PG8_STAGE(PG8_SB(0, 1), b2 + hstep, voffB);
            PG8_WAIT_V(6); PG8_BAR; PG8_MMA(1, 1, At, B1); PG8_BAR;
            PG8_LDB(B0, 1, 0); PG8_SCHED; PG8_LDA(At, 1, 0); PG8_STAGE(PG8_SA(0, 1), a2 + hstep, voffA);
            PG8_WAIT_L(8); PG8_BAR; PG8_WAIT_L(0); PG8_MMA(0, 0, At, B0); PG8_BAR; PG8_SCHED;
            PG8_LDB(B1, 1, 1); PG8_STAGE(PG8_SB(1, 0), b3, voffB);
            PG8_BAR; PG8_WAIT_L(0); PG8_MMA(0, 1, At, B1); PG8_BAR;
            PG8_LDA(At, 1, 1); PG8_STAGE(PG8_SA(1, 0), a3, voffA);
            PG8_BAR; PG8_WAIT_L(0); PG8_MMA(1, 0, At, B0); PG8_BAR; PG8_SCHED;
            PG8_STAGE(PG8_SB(1, 1), b3 + hstep, voffB);
            PG8_WAIT_V(6); PG8_BAR; PG8_MMA(1, 1, At, B1); PG8_BAR;
            }
        }
        if constexpr (ALIGN_EPI) { if (wr == 0) PG8_BAR; }
        if constexpr (!Epi::AFTER_DRAIN) { E(acc, cur, wr, wc, fr, fq); S.done(cur); }
        if (!has_next) break;
#pragma unroll
        for (int a = 0; a < 2; ++a)
#pragma unroll
            for (int b = 0; b < 2; ++b)
#pragma unroll
                for (int m = 0; m < 4; ++m)
#pragma unroll
                    for (int n = 0; n < 2; ++n) acc[a][b][m][n] = (f32x4){0.f, 0.f, 0.f, 0.f};
        cur = nxt; cA = nA; cB = nB; ++ui;
        if constexpr (ALIGN_EPI) { if (wr == 1) PG8_BAR; }
    }
    PG8_WAIT_V(0);
    if constexpr (!ALIGN_EPI) { if (wr == 0) PG8_BAR; }
    PG8_BAR;
    if constexpr (Epi::AFTER_DRAIN) { E.fused(acc, cur, wr, wc, fr, fq, lds, wid, lane); S.done(cur); }
#undef PG8_SA
#undef PG8_SB
#undef PG8_STAGE
#undef PG8_LDA
#undef PG8_LDB
#undef PG8_MMA
#undef PG8_WAIT_V
#undef PG8_WAIT_L
#undef PG8_BAR
#undef PG8_SCHED
}
}

namespace pg8 {
struct EpiU {
    static constexpr bool PERM = true, AFTER_DRAIN = false;
    bf16_t* O; const float* bias;
    __device__ __forceinline__ void operator()(const f32x4 (&acc)[2][2][4][2], const Unit& u, int wr, int wc, int fr, int fq) const {
        const int row0 = u.pm * BM + wr * 64 + fr; const int colt = u.pn * BM;
        const float sc = (u.pn == 2 || u.pn == 3) ? 0.08838834764831845f : ((u.pn == 10 || u.pn == 11) ? 0.125f : 1.0f);
        const int col0 = colt + wc * 32 + 8 * fq, bcol0 = col0 + (colt >= 2560 ? 8 : 0);
        f32x4 bv[2][2];
#pragma unroll
        for (int bj = 0; bj < 2; ++bj)
#pragma unroll
            for (int n = 0; n < 2; ++n) bv[bj][n] = *(const f32x4*)(bias + bcol0 + bj * HALF + 4 * n);
#pragma unroll
        for (int ai = 0; ai < 2; ++ai)
#pragma unroll
            for (int m = 0; m < 4; ++m) { bf16_t* rowp = O + (size_t)(row0 + ai * HALF + m * 16) * 3840 + col0;
#pragma unroll
                for (int bj = 0; bj < 2; ++bj) { f32x4 v0 = (acc[ai][bj][m][0] + bv[bj][0]) * sc, v1 = (acc[ai][bj][m][1] + bv[bj][1]) * sc;
                    u32x4 w; w.x = cvt_pk_bf16(v0[0], v0[1]); w.y = cvt_pk_bf16(v0[2], v0[3]); w.z = cvt_pk_bf16(v1[0], v1[1]); w.w = cvt_pk_bf16(v1[2], v1[3]);
                    *(u32x4*)(rowp + bj * HALF) = w; } }
    }
};
struct EpiMix {
    static constexpr bool PERM = true, AFTER_DRAIN = false;
    float* O; const bf16_t* HP; float alpha;
    __device__ __forceinline__ void operator()(const f32x4 (&acc)[2][2][4][2], const Unit& u, int wr, int wc, int fr, int fq) const {
        const int row0 = u.pm * BM + wr * 64 + fr; const int col0 = u.pn * BM + wc * 32 + 8 * fq;
#pragma unroll
        for (int ai = 0; ai < 2; ++ai)
#pragma unroll
            for (int m = 0; m < 4; ++m) { const size_t off = (size_t)(row0 + ai * HALF + m * 16) * 1024 + col0;
#pragma unroll
                for (int bj = 0; bj < 2; ++bj) { const u32x4 h = *(const u32x4*)(HP + off + bj * HALF);
                    const f32x4 r0 = {__uint_as_float(h.x << 16), __uint_as_float(h.x & 0xffff0000u), __uint_as_float(h.y << 16), __uint_as_float(h.y & 0xffff0000u)};
                    const f32x4 r1 = {__uint_as_float(h.z << 16), __uint_as_float(h.z & 0xffff0000u), __uint_as_float(h.w << 16), __uint_as_float(h.w & 0xffff0000u)};
                    *(f32x4*)(O + off + bj * HALF) = acc[ai][bj][m][0] + r0 * alpha; *(f32x4*)(O + off + bj * HALF + 4) = acc[ai][bj][m][1] + r1 * alpha; } }
    }
};
}

constexpr int NWAVES = 8;
constexpr int D = 1024, NB = 2, SEQ = 8192, NMETA = 16, PADF = 112, RB = 8320  , NCH = 65;
constexpr int DBATCH = 128, DL = 4, NS = DBATCH * DL, SROW0 = NB * RB  , M = SROW0 + NS  ;
constexpr int NU = 3840, NIN = 3848;
constexpr int C_MQ = 0, C_MK = 512, C_MV = 1024, C_MO = 1536, C_MZ = 2048, C_AQ = 2560, C_AK = 3072, C_AV = 3200, C_AZ = 3328;
constexpr float LN_EPS = 1e-5f, DN_ALPHA = 1.189207115002721f;
constexpr size_t OFF_YP = 0, OFF_YS = 16777216, OFF_PK = 17301504, OFF_PV = 17338368, OFF_PC = 17375232, OFF_PN = 17506304, OFF_PM = 17507328,
                 OFF_SK = 17507336, OFF_SV = 19866632, OFF_SC = 22225928, OFF_SN = 30614536, OFF_SM = 30680072, OUT_TOTAL = 30680584;
constexpr size_t MiB = 1u << 20;
constexpr size_t WS_CTL = 0, CTL_ZERO_BYTES = 256 * 1024;
constexpr size_t WS_WTIN = 1 * MiB, WS_WTOUT = 9 * MiB, WS_LOGI = 11 * MiB, WS_LOGF = 11 * MiB + 512 * 1024, WS_MJ = 12 * MiB, WS_NST = 13 * MiB;
constexpr size_t WS_HP = 14 * MiB, WS_U = 48 * MiB, WS_MIX = 48 * MiB  , WS_CST = 174 * MiB, WS_Y = 191 * MiB, WS_END = 226 * MiB;
constexpr int CW_BAR = 4096;
constexpr int RING_BYTES = 131072, LDSCTL_OFF = RING_BYTES, MISC_OFF = LDSCTL_OFF + 320, LDS_BYTES = 147456;

#define GAS __attribute__((address_space(1)))
#define LAS __attribute__((address_space(3)))
typedef unsigned short bf16;
typedef unsigned v4u __attribute__((ext_vector_type(4)));
typedef unsigned v2u __attribute__((ext_vector_type(2)));
typedef float f32x4 __attribute__((ext_vector_type(4)));
typedef float f32x2 __attribute__((ext_vector_type(2)));
typedef short bf16x8 __attribute__((ext_vector_type(8)));
typedef short s16x4 __attribute__((ext_vector_type(4)));
typedef short v4i16_t __attribute__((ext_vector_type(4)));
typedef LAS unsigned char* ldsp;
#define LDS_WAIT() asm volatile("s_waitcnt lgkmcnt(0)" ::: "memory")

__device__ __forceinline__ unsigned f2bf(float f) { unsigned u = __builtin_bit_cast(unsigned, f); return (u + 0x7fffu + ((u >> 16) & 1u)) >> 16; }
__device__ __forceinline__ unsigned pk2(float lo, float hi) { return f2bf(lo) | (f2bf(hi) << 16); }
__device__ __forceinline__ float bflo(unsigned w) { return __uint_as_float(w << 16); }
__device__ __forceinline__ float bfhi(unsigned w) { return __uint_as_float(w & 0xffff0000u); }
__device__ __forceinline__ float bf1(short s) { return __uint_as_float(((unsigned)(unsigned short)s) << 16); }
__device__ __forceinline__ s16x4 trr(ldsp p) { return __builtin_bit_cast(s16x4, __builtin_amdgcn_ds_read_tr16_b64_v4i16((LAS v4i16_t*)p)); }
__device__ __forceinline__ f32x4 mfma16(bf16x8 a, bf16x8 b, f32x4 c) { return __builtin_amdgcn_mfma_f32_16x16x32_bf16(a, b, c, 0, 0, 0); }
__device__ __forceinline__ bf16x8 cat8(s16x4 lo, s16x4 hi) { return (bf16x8){lo[0], lo[1], lo[2], lo[3], hi[0], hi[1], hi[2], hi[3]}; }
__device__ __forceinline__ bf16x8 packp(f32x4 a, f32x4 b) { v4u w; w.x = pk2(a[0], a[1]); w.y = pk2(a[2], a[3]); w.z = pk2(b[0], b[1]); w.w = pk2(b[2], b[3]); return __builtin_bit_cast(bf16x8, w); }
__device__ __forceinline__ float wave_sum(float v) {
#pragma unroll
    for (int o = 1; o < 64; o <<= 1) v += __shfl_xor(v, o);
    return v;
}
__device__ __forceinline__ float wave_max(float v) {
#pragma unroll
    for (int o = 1; o < 64; o <<= 1) v = fmaxf(v, __shfl_xor(v, o));
    return v;
}
__device__ __forceinline__ float sigmoidf_(float x) { return 1.0f / (1.0f + __expf(-x)); }
__device__ __forceinline__ float siluf_(float x) { return x / (1.0f + __expf(-x)); }
__device__ __forceinline__ float logsigmoidf_(float x) { return fminf(x, 0.0f) - log1pf(expf(-fabsf(x))); }
#define XB_TMO      128
#define XB_XCNT(j)  (256  + 64 * (j))
#define XB_XSUB(j)  (1280 + 64 * (j))
#define XB_XGEN(j)  (2304 + 64 * (j))
#define XB_TOP      3328
#define XB_TOPGEN   3392
#define XCD_BAR_WORDS 3456
#define XB_SPIN_CAP (1u << 18)

__device__ __forceinline__ unsigned xb_ld(unsigned* p)              { return __hip_atomic_load(p, __ATOMIC_RELAXED, __HIP_MEMORY_SCOPE_AGENT); }
__device__ __forceinline__ unsigned xb_add(unsigned* p, unsigned v) { return __hip_atomic_fetch_add(p, v, __ATOMIC_RELAXED, __HIP_MEMORY_SCOPE_AGENT); }
__device__ __forceinline__ unsigned xb_xcc_id() { return (unsigned)__builtin_amdgcn_s_getreg((3 << 11) | 20) & 0xFu; }
#define XB_SPIN(cond, bar) do { unsigned _sp = 0; while (cond) { __builtin_amdgcn_s_sleep(1); \
    if ((++_sp & 255u) == 0u) { if (xb_ld(&(bar)[XB_TMO])) break; if (_sp > XB_SPIN_CAP) { atomicAdd(&(bar)[XB_TMO], 1u); break; } } } } while (0)

struct XcdBarrier {
    unsigned* bar; unsigned x;
    volatile LAS unsigned* st;
};

__device__ __forceinline__ XcdBarrier xcd_barrier_post(unsigned* bar, volatile LAS unsigned* st) {
    XcdBarrier b; b.bar = bar; b.x = xb_xcc_id(); b.st = st;
    if (threadIdx.x == 0) (void)xb_add(&bar[XB_XCNT(b.x)], 1u);
    return b;
}
__device__ __forceinline__ void xcd_barrier_complete(unsigned* bar, unsigned x, unsigned& nloc, unsigned& nx) {
    const unsigned G = gridDim.x * gridDim.y * gridDim.z;
    unsigned sum, cnt, mine, sp = 0u;
    for (;;) {
        sum = 0u; cnt = 0u; mine = 0u;
#pragma unroll
        for (unsigned j = 0; j < 16; ++j) { const unsigned c = xb_ld(&bar[XB_XCNT(j)]); sum += c; cnt += (c > 0u) ? 1u : 0u; mine = (j == x) ? c : mine; }
        if (sum == G) break;
        __builtin_amdgcn_s_sleep(1);
        if ((++sp & 255u) == 0u) { if (xb_ld(&bar[XB_TMO])) break; if (sp > XB_SPIN_CAP) { atomicAdd(&bar[XB_TMO], 1u); break; } }
    }
    nloc = mine > 0u ? mine : 1u; nx = cnt > 0u ? cnt : 1u;
}

__device__ __forceinline__ void xcd_barrier(const XcdBarrier& b) {
    asm volatile("s_waitcnt vmcnt(0)" ::: "memory");
    __syncthreads();
    if (threadIdx.x == 0) {
        unsigned* bar = b.bar;
        __builtin_amdgcn_s_waitcnt(0);
        unsigned nloc = b.st[0], nx = b.st[1];
        if (nloc == 0u) { xcd_barrier_complete(bar, b.x, nloc, nx); b.st[0] = nloc; b.st[1] = nx; }
        const unsigned old = xb_add(&bar[XB_XSUB(b.x)], 1u);
        const unsigned gen = old / nloc;
        if (old + 1u == (gen + 1u) * nloc) {
            __builtin_amdgcn_fence(__ATOMIC_RELEASE, "agent");
            asm volatile("s_waitcnt vmcnt(0)" ::: "memory");
            const unsigned og = xb_add(&bar[XB_TOP], 1u);
            const unsigned tg = og / nx;
            if (og + 1u == (tg + 1u) * nx) xb_add(&bar[XB_TOPGEN], 1u);
            else XB_SPIN(xb_ld(&bar[XB_TOPGEN]) == tg, bar);
            __builtin_amdgcn_fence(__ATOMIC_ACQUIRE, "agent");
            xb_add(&bar[XB_XGEN(b.x)], 1u);
            asm volatile("s_waitcnt vmcnt(0)" ::: "memory");
        } else {
            XB_SPIN(xb_ld(&bar[XB_XGEN(b.x)]) == gen, bar);
            __builtin_amdgcn_fence(__ATOMIC_ACQUIRE, "agent");
            asm volatile("s_waitcnt vmcnt(0)" ::: "memory");
        }
    }
    __syncthreads();
}

struct Ctx {
    ldsp lds; int tid, lane, wave, vcu, G;
    const float *x_prompt, *x_sample, *cache_k, *cache_v, *st_c, *st_n, *st_m, *meta, *ln0_g, *ln0_b, *w_in, *b_in, *sinks, *norm_g, *w_out, *ln_g, *ln_b;
    float* out;
    bf16 *WTIN, *WTOUT, *HP, *U, *CST, *Y; float *LOGI, *LOGF, *MJ, *NST, *MIX;
};

__device__ __forceinline__ void p0_transpose_item(const float* W, int ldw, int K, bf16* WT, int n0d, int n0s, int k0, LAS float* scr, int lane) {
#pragma unroll 8
    for (int i = 0; i < 32; ++i) { const int kk = 2 * i + (lane >> 5); scr[kk * 33 + (lane & 31)] = W[(size_t)(k0 + kk) * ldw + n0s + (lane & 31)]; }
    LDS_WAIT(); asm volatile("" ::: "memory");
    const int c = lane & 7;
#pragma unroll
    for (int j = 0; j < 4; ++j) { const int n = (lane >> 3) + 8 * j; const LAS float* s = scr + (8 * c) * 33 + n;
        v4u o; o.x = pk2(s[0 * 33], s[1 * 33]); o.y = pk2(s[2 * 33], s[3 * 33]); o.z = pk2(s[4 * 33], s[5 * 33]); o.w = pk2(s[6 * 33], s[7 * 33]);
        *(v4u*)(WT + (size_t)(n0d + n) * K + k0 + 8 * c) = o; }
    LDS_WAIT(); asm volatile("" ::: "memory");
}

__device__ __forceinline__ void p0_prologue(Ctx& F) {
    LAS float* scr = (LAS float*)(F.lds + F.wave * 16384);
    const int gw = F.vcu * NWAVES + F.wave, NGW = F.G * NWAVES;
    constexpr int I_IN = 16 * 120, I_OUT = 16 * 32;
    for (int it = gw; it < I_IN + I_OUT; it += NGW) {
        if (it < I_IN) { const int kb = it / 120, nb = it % 120, n0d = nb * 32, n0s = n0d + (n0d >= 2560 ? 8 : 0); p0_transpose_item(F.w_in, NIN, D, F.WTIN, n0d, n0s, kb * 64, scr, F.lane); }
        else { const int r = it - I_IN, kb = r / 32, nb = r % 32; p0_transpose_item(F.w_out, D, D, F.WTOUT, nb * 32, nb * 32, kb * 64, scr, F.lane); }
    }
    __syncthreads();
    LAS float* wg = (LAS float*)F.lds;
    for (int idx = F.tid; idx < 8192; idx += NWAVES * 64) { const int g = idx & 7, k = idx >> 3; wg[g * 1024 + k] = F.w_in[(size_t)k * NIN + 2560 + g]; }
    __syncthreads();
    f32x4 gg[4], bb[4];
#pragma unroll
    for (int j = 0; j < 4; ++j) { gg[j] = ((const f32x4*)F.ln0_g)[F.lane + 64 * j]; bb[j] = ((const f32x4*)F.ln0_b)[F.lane + 64 * j]; }
    const float bgate = F.b_in[2560 + (F.lane & 7)];
    for (int row = gw; row < M; row += NGW) {
        const float* src = nullptr; bool dummy = false;
        if (row < SROW0) { const int b = row / RB, r = row - b * RB;
            if (r < PADF) dummy = true; else { const int t = r - PADF; src = t < NMETA ? F.meta + (size_t)t * D : F.x_prompt + ((size_t)b * SEQ + (t - NMETA)) * D; } }
        else src = F.x_sample + (size_t)(row - SROW0) * D;
        unsigned long long* o8 = (unsigned long long*)(F.HP + (size_t)row * D) + F.lane;
        if (dummy) {
#pragma unroll
            for (int j = 0; j < 4; ++j) o8[64 * j] = 0ull;
            if (F.lane < 4) { F.LOGI[row * 4 + F.lane] = -1e30f; F.LOGF[row * 4 + F.lane] = 0.f; }
            continue;
        }
        const f32x4* xr = (const f32x4*)src + F.lane;
        f32x4 v[4]; float s = 0.f;
#pragma unroll
        for (int j = 0; j < 4; ++j) { v[j] = xr[64 * j]; s += (v[j].x + v[j].y) + (v[j].z + v[j].w); }
        const float mean = wave_sum(s) * (1.f / D); float s2 = 0.f;
#pragma unroll
        for (int j = 0; j < 4; ++j) { v[j] = v[j] - mean; s2 += (v[j].x * v[j].x + v[j].y * v[j].y) + (v[j].z * v[j].z + v[j].w * v[j].w); }
        const float rstd = 1.f / sqrtf(wave_sum(s2) * (1.f / D) + LN_EPS);
#pragma unroll
        for (int j = 0; j < 4; ++j) { v[j] = v[j] * rstd * gg[j] + bb[j];
            o8[64 * j] = (unsigned long long)pk2(v[j].x, v[j].y) | ((unsigned long long)pk2(v[j].z, v[j].w) << 32); }
        float val = 0.f;
#pragma unroll
        for (int g = 0; g < 8; ++g) { float a = 0.f;
#pragma unroll
            for (int j = 0; j < 4; ++j) { const f32x4 w4 = *(const LAS f32x4*)(wg + g * 1024 + 256 * j + 4 * F.lane); a += (v[j].x * w4.x + v[j].y * w4.y) + (v[j].z * w4.z + v[j].w * w4.w); }
            a = wave_sum(a); if (F.lane == g) val = a; }
        val += bgate;
        if (F.lane < 4) F.LOGI[row * 4 + F.lane] = val; else if (F.lane < 8) F.LOGF[row * 4 + F.lane - 4] = logsigmoidf_(val);
    }
    __syncthreads();
}

constexpr int CH_KS = 160;
constexpr int CH_STAGE = 2 * 128 * CH_KS;
constexpr int CH_BJ = 2 * CH_STAGE, CH_MX = CH_BJ + 512, CH_MS = CH_MX + 512, CH_E = CH_MS + 512;

__device__ __forceinline__ void chain_block(Ctx& F, int bh, int quad) {
    const int b = bh >> 2, h = bh & 3, dkq = quad >> 1, dvq = quad & 1;
    const int lane = F.lane, wave = F.wave, tid = F.tid;
    LAS float* Bj = (LAS float*)(F.lds + CH_BJ); LAS float* Mx = (LAS float*)(F.lds + CH_MX); LAS float* ms = (LAS float*)(F.lds + CH_MS); LAS float* E = (LAS float*)(F.lds + CH_E);
    for (int j = wave; j < NCH; j += NWAVES) {
        const int row = b * RB + j * 128 + 2 * lane;
        const float f0 = F.LOGF[row * 4 + h], f1 = F.LOGF[(row + 1) * 4 + h], i0 = F.LOGI[row * 4 + h], i1 = F.LOGI[(row + 1) * 4 + h];
        const float s2 = f0 + f1; float inc = s2;
#pragma unroll
        for (int o = 1; o < 64; o <<= 1) { const float t = __shfl_up(inc, o); if (lane >= o) inc += t; }
        const float tot = __shfl(inc, 63), b0 = inc - s2 + f0, b1 = inc;
        const float e0 = tot - b0 + i0, e1 = tot - b1 + i1;
        E[j * 128 + 2 * lane] = e0; E[j * 128 + 2 * lane + 1] = e1;
        const float mx = wave_max(fmaxf(e0, e1));
        if (lane == 0) { Bj[j] = tot; Mx[j] = mx; }
    }
    __syncthreads();
    if (tid == 0) { float m = 0.f; for (int j = 0; j < NCH; ++j) { ms[j] = m; m = fmaxf(Bj[j] + m, Mx[j]); } ms[NCH] = m; }
    __syncthreads();
    if (quad == 0 && tid <= NCH) F.MJ[bh * 66 + tid] = ms[tid];
    for (int idx = tid; idx < NCH * 128; idx += NWAVES * 64) E[idx] = __expf(E[idx] - ms[(idx >> 7) + 1]);
    const int pr0 = tid >> 3, pc = tid & 7;
    const bf16* gK = F.U + (size_t)(b * RB + pr0) * NU + C_MK + h * 128 + dkq * 64 + pc * 8;
    const bf16* gV = F.U + (size_t)(b * RB + pr0) * NU + C_MV + h * 128 + dvq * 64 + pc * 8;
    const int lo0 = pr0 * CH_KS + pc * 16, lo1 = (pr0 + 64) * CH_KS + pc * 16;
#define CH_LOAD(R, j) do { const size_t _o = (size_t)(j) * 128 * NU; R[0] = *(const v4u*)(gK + _o); R[1] = *(const v4u*)(gK + _o + (size_t)64 * NU); \
                           R[2] = *(const v4u*)(gV + _o); R[3] = *(const v4u*)(gV + _o + (size_t)64 * NU); } while (0)
#define CH_STORE(R, st) do { ldsp _s = F.lds + (st) * CH_STAGE; *(LAS v4u*)(_s + lo0) = R[0]; *(LAS v4u*)(_s + lo1) = R[1]; \
                             *(LAS v4u*)(_s + 128 * CH_KS + lo0) = R[2]; *(LAS v4u*)(_s + 128 * CH_KS + lo1) = R[3]; } while (0)
    v4u RA[4], RB_[4];
    CH_LOAD(RA, 0); CH_STORE(RA, 0);
    CH_LOAD(RA, 1); CH_LOAD(RB_, 2);
    __syncthreads();
    const int g4 = lane >> 4, r16 = lane & 15, q = r16 >> 2, p = r16 & 3;
    const int dkt = wave & 3, dvt0 = 2 * (wave >> 2);
    f32x4 acc[2] = {{0.f, 0.f, 0.f, 0.f}, {0.f, 0.f, 0.f, 0.f}};
    float nacc = 0.f;
    const bool do_n = (dvq == 0) && (wave == 0);
    for (int j = 0; j < NCH; ++j) {
        const int st = j & 1;
        ldsp Ks = F.lds + st * CH_STAGE, Vs = Ks + 128 * CH_KS;
        const float dec = __expf(Bj[j] + ms[j] - ms[j + 1]);
#pragma unroll
        for (int t = 0; t < 2; ++t) { const int dv = dvq * 64 + 16 * (dvt0 + t) + r16, dk = dkq * 64 + 16 * dkt + 4 * g4;
            v2u w; w.x = pk2(acc[t][0], acc[t][1]); w.y = pk2(acc[t][2], acc[t][3]);
            *(v2u*)(F.CST + ((size_t)(bh * NCH + j) * 128 + dv) * 128 + dk) = w; acc[t] = acc[t] * dec; }
#pragma unroll
        for (int ks = 0; ks < 4; ++ks) {
            const int rlo = 32 * ks + 4 * g4 + q, rhi = rlo + 16;
            const s16x4 alo = trr(Ks + rlo * CH_KS + (16 * dkt + 4 * p) * 2), ahi = trr(Ks + rhi * CH_KS + (16 * dkt + 4 * p) * 2);
            const f32x4 wl = *(const LAS f32x4*)(E + j * 128 + 32 * ks + 4 * g4), wh = *(const LAS f32x4*)(E + j * 128 + 32 * ks + 16 + 4 * g4);
            const f32x4 fa = {bf1(alo[0]) * wl[0], bf1(alo[1]) * wl[1], bf1(alo[2]) * wl[2], bf1(alo[3]) * wl[3]};
            const f32x4 fb = {bf1(ahi[0]) * wh[0], bf1(ahi[1]) * wh[1], bf1(ahi[2]) * wh[2], bf1(ahi[3]) * wh[3]};
            const bf16x8 a = packp(fa, fb);
#pragma unroll
            for (int t = 0; t < 2; ++t) {
                const s16x4 blo = trr(Vs + rlo * CH_KS + (16 * (dvt0 + t) + 4 * p) * 2), bhi = trr(Vs + rhi * CH_KS + (16 * (dvt0 + t) + 4 * p) * 2);
                acc[t] = mfma16(a, cat8(blo, bhi), acc[t]);
            }
        }
        if (do_n) {
            F.NST[(size_t)(bh * NCH + j) * 128 + dkq * 64 + lane] = nacc;
            float s = 0.f;
#pragma unroll 8
            for (int tok = 0; tok < 128; ++tok) s += E[j * 128 + tok] * __uint_as_float(((unsigned)*(const LAS unsigned short*)(Ks + tok * CH_KS + lane * 2)) << 16);
            nacc = dec * nacc + s;
        }
        if (st == 0) { if (j + 1 < NCH) CH_STORE(RA, 1); if (j + 3 < NCH) CH_LOAD(RA, j + 3); }
        else         { if (j + 1 < NCH) CH_STORE(RB_, 0); if (j + 3 < NCH) CH_LOAD(RB_, j + 3); }
        __syncthreads();
    }
#undef CH_LOAD
#undef CH_STORE
#pragma unroll
    for (int t = 0; t < 2; ++t) { const int dv = dvq * 64 + 16 * (dvt0 + t) + r16, dk = dkq * 64 + 16 * dkt + 4 * g4;
#pragma unroll
        for (int r = 0; r < 4; ++r) F.out[OFF_PC + ((size_t)bh * 128 + dk + r) * 128 + dv] = acc[t][r]; }
    if (do_n) F.out[OFF_PN + (size_t)bh * 128 + dkq * 64 + lane] = nacc;
    if (quad == 0 && tid == 0) F.out[OFF_PM + bh] = ms[NCH];
    __syncthreads();
}

constexpr int SW_KS = 160;
template <int NT, class RowF, class MaskF>
__device__ __forceinline__ void swa_qtile(const bf16* qptr, float sink, ldsp Kt, ldsp Vt, RowF rowf, MaskF maskf, const bf16* zptr, bf16* yptr, int lane) {
    const int g4 = lane >> 4, r16 = lane & 15, q = r16 >> 2, p = r16 & 3;
    bf16x8 qf[2];
#pragma unroll
    for (int ks = 0; ks < 2; ++ks) qf[ks] = *(const bf16x8*)(qptr + 32 * ks + 8 * g4);
    f32x4 S[NT];
    float mx = sink;
#pragma unroll
    for (int ti = 0; ti < NT; ++ti) {
        const int kr = rowf(ti);
        f32x4 s = {0.f, 0.f, 0.f, 0.f};
#pragma unroll
        for (int ks = 0; ks < 2; ++ks) { const bf16x8 a = *(const LAS bf16x8*)(Kt + (kr + r16) * SW_KS + (32 * ks + 8 * g4) * 2); s = mfma16(a, qf[ks], s); }
#pragma unroll
        for (int r = 0; r < 4; ++r) { s[r] = maskf(ti, 4 * g4 + r) ? s[r] : -INFINITY; mx = fmaxf(mx, s[r]); }
        S[ti] = s;
    }
    mx = fmaxf(mx, __shfl_xor(mx, 16)); mx = fmaxf(mx, __shfl_xor(mx, 32));
    float sum = 0.f;
#pragma unroll
    for (int ti = 0; ti < NT; ++ti)
#pragma unroll
        for (int r = 0; r < 4; ++r) { const float e = __expf(S[ti][r] - mx); S[ti][r] = e; sum += e; }
    sum += __shfl_xor(sum, 16); sum += __shfl_xor(sum, 32);
    sum += __expf(sink - mx);
    const float inv = 1.0f / sum;
    f32x4 O[4];
#pragma unroll
    for (int d = 0; d < 4; ++d) O[d] = (f32x4){0.f, 0.f, 0.f, 0.f};
#pragma unroll
    for (int kp = 0; kp < NT / 2; ++kp) {
        const bf16x8 pb = packp(S[2 * kp], S[2 * kp + 1]);
        const int ra = rowf(2 * kp) + 4 * g4 + q, rb = rowf(2 * kp + 1) + 4 * g4 + q;
#pragma unroll
        for (int d = 0; d < 4; ++d) { const s16x4 lo = trr(Vt + ra * SW_KS + (16 * d + 4 * p) * 2), hi = trr(Vt + rb * SW_KS + (16 * d + 4 * p) * 2);
            O[d] = mfma16(cat8(lo, hi), pb, O[d]); }
    }
#pragma unroll
    for (int d = 0; d < 4; ++d) { const int dv = 16 * d + 4 * g4; const v2u z = *(const v2u*)(zptr + dv);
        v2u w; w.x = pk2(O[d][0] * inv * siluf_(bflo(z.x)), O[d][1] * inv * siluf_(bfhi(z.x))); w.y = pk2(O[d][2] * inv * siluf_(bflo(z.y)), O[d][3] * inv * siluf_(bfhi(z.y)));
        *(v2u*)(yptr + dv) = w; }
}

__device__ __forceinline__ void swa_prompt_item(Ctx& F, int b, int n, int kvh) {
    ldsp Kt = F.lds, Vt = F.lds + 272 * SW_KS;
    for (int pc = F.tid; pc < 272 * 8; pc += NWAVES * 64) { const int kr = pc >> 3, c = pc & 7;
        const int grow = b * RB + (kr < 16 ? PADF + kr : 128 * n + (kr - 16));
        const bf16* src = F.U + (size_t)grow * NU + kvh * 64 + c * 8;
        *(LAS v4u*)(Kt + kr * SW_KS + c * 16) = *(const v4u*)(src + C_AK); *(LAS v4u*)(Vt + kr * SW_KS + c * 16) = *(const v4u*)(src + C_AV); }
    __syncthreads();
    const int hq = kvh * 4 + (F.wave >> 1); const float sink = F.sinks[hq];
    const int r16 = F.lane & 15;
#pragma unroll 1
    for (int t = 0; t < 4; ++t) { const int qt = 4 * (F.wave & 1) + t; const int ql = 16 * qt + r16;
        const size_t row = (size_t)b * RB + 128 * (n + 1) + ql;
        swa_qtile<10>(F.U + row * NU + C_AQ + hq * 64, sink, Kt, Vt,
            [=](int ti) { return ti == 0 ? 0 : 16 + 16 * (qt + ti - 1); },
            [=](int ti, int kk) { if (ti == 0) return true; const int c = 16 * (qt + ti - 1) + kk; return (c >= ql + 1) && (c <= ql + 128) && (n > 0 || c >= 128); },
            F.U + row * NU + C_AZ + hq * 64, F.Y + row * D + 512 + hq * 64, F.lane); }
    __syncthreads();
}
__device__ __forceinline__ void swa_meta_item(Ctx& F, int b, int kvh) {
    ldsp Kt = F.lds, Vt = F.lds + 272 * SW_KS;
    for (int pc = F.tid; pc < 16 * 8; pc += NWAVES * 64) { const int kr = pc >> 3, c = pc & 7;
        const bf16* src = F.U + (size_t)(b * RB + PADF + kr) * NU + kvh * 64 + c * 8;
        *(LAS v4u*)(Kt + kr * SW_KS + c * 16) = *(const v4u*)(src + C_AK); *(LAS v4u*)(Vt + kr * SW_KS + c * 16) = *(const v4u*)(src + C_AV); }
    __syncthreads();
    if (F.wave < 4) { const int hq = kvh * 4 + F.wave; const int r16 = F.lane & 15; const size_t row = (size_t)b * RB + PADF + r16;
        swa_qtile<2>(F.U + row * NU + C_AQ + hq * 64, F.sinks[hq], Kt, Vt, [=](int) { return 0; }, [=](int ti, int kk) { return ti == 0 && kk <= r16; },
            F.U + row * NU + C_AZ + hq * 64, F.Y + row * D + 512 + hq * 64, F.lane); }
    __syncthreads();
}
__device__ __forceinline__ void swa_sample_item(Ctx& F, int db, int kvh) {
    ldsp Kt = F.lds, Vt = F.lds + 272 * SW_KS;
    for (int pc = F.tid; pc < 160 * 8; pc += NWAVES * 64) { const int kr = pc >> 3, c = pc & 7;
        v4u wk = {0u, 0u, 0u, 0u}, wv = {0u, 0u, 0u, 0u};
        if (kr < 144) {
            const size_t so = ((size_t)(db * 144 + kr) * 2 + kvh) * 64 + c * 8;
            const f32x4 k0 = *(const f32x4*)(F.cache_k + so), k1 = *(const f32x4*)(F.cache_k + so + 4), v0 = *(const f32x4*)(F.cache_v + so), v1 = *(const f32x4*)(F.cache_v + so + 4);
            wk.x = pk2(k0[0], k0[1]); wk.y = pk2(k0[2], k0[3]); wk.z = pk2(k1[0], k1[1]); wk.w = pk2(k1[2], k1[3]);
            wv.x = pk2(v0[0], v0[1]); wv.y = pk2(v0[2], v0[3]); wv.z = pk2(v1[0], v1[1]); wv.w = pk2(v1[2], v1[3]);
            if (kr < 16 || kr >= 20) { const int ro = kr < 16 ? kr : kr - 4; const size_t oo = ((size_t)(db * 144 + ro) * 2 + kvh) * 64 + c * 8;
                *(f32x4*)(F.out + OFF_SK + oo) = k0; *(f32x4*)(F.out + OFF_SK + oo + 4) = k1; *(f32x4*)(F.out + OFF_SV + oo) = v0; *(f32x4*)(F.out + OFF_SV + oo + 4) = v1; }
        } else if (kr < 148) {
            const bf16* src = F.U + (size_t)(SROW0 + db * 4 + (kr - 144)) * NU + kvh * 64 + c * 8;
            wk = *(const v4u*)(src + C_AK); wv = *(const v4u*)(src + C_AV);
            const size_t oo = ((size_t)(db * 144 + 140 + (kr - 144)) * 2 + kvh) * 64 + c * 8;
            *(f32x4*)(F.out + OFF_SK + oo) = (f32x4){bflo(wk.x), bfhi(wk.x), bflo(wk.y), bfhi(wk.y)}; *(f32x4*)(F.out + OFF_SK + oo + 4) = (f32x4){bflo(wk.z), bfhi(wk.z), bflo(wk.w), bfhi(wk.w)};
            *(f32x4*)(F.out + OFF_SV + oo) = (f32x4){bflo(wv.x), bfhi(wv.x), bflo(wv.y), bfhi(wv.y)}; *(f32x4*)(F.out + OFF_SV + oo + 4) = (f32x4){bflo(wv.z), bfhi(wv.z), bflo(wv.w), bfhi(wv.w)};
        }
        *(LAS v4u*)(Kt + kr * SW_KS + c * 16) = wk; *(LAS v4u*)(Vt + kr * SW_KS + c * 16) = wv; }
    __syncthreads();
    if (F.wave == 0) { const int r16 = F.lane & 15, l = r16 >> 2, g = r16 & 3, hq = kvh * 4 + g; const size_t row = (size_t)SROW0 + db * 4 + l;
        swa_qtile<10>(F.U + row * NU + C_AQ + hq * 64, F.sinks[hq], Kt, Vt, [=](int ti) { return 16 * ti; },
            [=](int ti, int kk) { const int key = 16 * ti + kk; if (key < 16) return true; if (key < 144) return (key - 16) > l; if (key < 148) return (key - 144) <= l; return false; },
            F.U + row * NU + C_AZ + hq * 64, F.Y + row * D + 512 + hq * 64, F.lane); }
    __syncthreads();
}

__device__ __forceinline__ void mlstm_sample_item(Ctx& F, int db, int h) {
    const int lane = F.lane;
    LAS float* qs = (LAS float*)(F.lds + F.wave * 16384); LAS float* ks = qs + 512;
    float qv[4][2], kv[4][2], vv[4][2], li[4], lf[4];
#pragma unroll
    for (int t = 0; t < 4; ++t) { const size_t ro = (size_t)(SROW0 + db * 4 + t) * NU + h * 128 + 2 * lane;
        const unsigned uq = *(const unsigned*)(F.U + ro + C_MQ), uk = *(const unsigned*)(F.U + ro + C_MK), uv = *(const unsigned*)(F.U + ro + C_MV);
        qv[t][0] = bflo(uq); qv[t][1] = bfhi(uq); kv[t][0] = bflo(uk); kv[t][1] = bfhi(uk); vv[t][0] = bflo(uv); vv[t][1] = bfhi(uv);
        *(LAS f32x2*)(qs + t * 128 + 2 * lane) = (f32x2){qv[t][0], qv[t][1]}; *(LAS f32x2*)(ks + t * 128 + 2 * lane) = (f32x2){kv[t][0], kv[t][1]};
        li[t] = F.LOGI[(SROW0 + db * 4 + t) * 4 + h]; lf[t] = F.LOGF[(SROW0 + db * 4 + t) * 4 + h]; }
    const float m0 = F.st_m[db * 4 + h];
    float bc[4], av[4], cm[4], mt[4];
    { float bsum = 0.f, c = m0;
#pragma unroll
      for (int t = 0; t < 4; ++t) { bsum += lf[t]; bc[t] = bsum; av[t] = li[t] - bsum; c = fmaxf(c, av[t]); cm[t] = c; mt[t] = bsum + c; } }
    float qk[4][4];
#pragma unroll
    for (int t = 0; t < 4; ++t)
#pragma unroll
        for (int s = 0; s < 4; ++s) qk[t][s] = (s <= t) ? wave_sum(qv[t][0] * kv[s][0] + qv[t][1] * kv[s][1]) : 0.f;
    const f32x2 nn = *(const f32x2*)(F.st_n + (size_t)(db * 4 + h) * 128 + 2 * lane);
    float qn[4];
#pragma unroll
    for (int t = 0; t < 4; ++t) qn[t] = wave_sum(qv[t][0] * nn[0] + qv[t][1] * nn[1]);
    float wts[4]; const float dec = __expf(m0 - cm[3]);
#pragma unroll
    for (int s = 0; s < 4; ++s) wts[s] = __expf(av[s] - cm[3]);
    { f32x2 n2 = nn * dec;
#pragma unroll
      for (int s = 0; s < 4; ++s) { n2[0] += wts[s] * kv[s][0]; n2[1] += wts[s] * kv[s][1]; }
      *(f32x2*)(F.out + OFF_SN + (size_t)(db * 4 + h) * 128 + 2 * lane) = n2; }
    if (lane == 0) F.out[OFF_SM + db * 4 + h] = mt[3];
    LDS_WAIT(); asm volatile("" ::: "memory");
    const float* Cin = F.st_c + (size_t)(db * 4 + h) * 16384 + 2 * lane; float* Cout = F.out + OFF_SC + (size_t)(db * 4 + h) * 16384 + 2 * lane;
    f32x2 qC[4];
#pragma unroll
    for (int t = 0; t < 4; ++t) qC[t] = (f32x2){0.f, 0.f};
    f32x2 wv[4];
#pragma unroll
    for (int s = 0; s < 4; ++s) wv[s] = (f32x2){wts[s] * vv[s][0], wts[s] * vv[s][1]};
#pragma unroll 1
    for (int dk0 = 0; dk0 < 128; dk0 += 8) {
        f32x2 c[8];
#pragma unroll
        for (int i = 0; i < 8; ++i) c[i] = *(const f32x2*)(Cin + (size_t)(dk0 + i) * 128);
#pragma unroll
        for (int i = 0; i < 8; ++i) { f32x2 cn = c[i] * dec;
#pragma unroll
            for (int t = 0; t < 4; ++t) { const float qd = qs[t * 128 + dk0 + i], kd = ks[t * 128 + dk0 + i]; qC[t] += c[i] * qd; cn += wv[t] * kd; }
            *(f32x2*)(Cout + (size_t)(dk0 + i) * 128) = cn; }
    }
#pragma unroll
    for (int t = 0; t < 4; ++t) {
        const float sint = __expf(m0 - cm[t]); f32x2 num = qC[t] * sint; float den = sint * qn[t];
#pragma unroll
        for (int s = 0; s < 4; ++s) if (s <= t) { const float w = qk[t][s] * __expf(av[s] - cm[t]); num[0] += w * vv[s][0]; num[1] += w * vv[s][1]; den += w; }
        const float inv = 1.0f / fmaxf(fabsf(den), __expf(-mt[t]));
        const size_t ro = (size_t)(SROW0 + db * 4 + t) * NU + h * 128 + 2 * lane;
        const unsigned uo = *(const unsigned*)(F.U + ro + C_MO), uz = *(const unsigned*)(F.U + ro + C_MZ);
        float h0 = num[0] * inv * sigmoidf_(bflo(uo)), h1 = num[1] * inv * sigmoidf_(bfhi(uo));
        const float mean = wave_sum(h0 + h1) * (1.f / 128.f); h0 -= mean; h1 -= mean;
        const float rstd = rsqrtf(wave_sum(h0 * h0 + h1 * h1) * (1.f / 128.f) + LN_EPS);
        const f32x2 ng = *(const f32x2*)(F.norm_g + h * 128 + 2 * lane);
        *(unsigned*)(F.Y + (size_t)(SROW0 + db * 4 + t) * D + h * 128 + 2 * lane) = pk2(h0 * rstd * ng[0] * siluf_(bflo(uz)), h1 * rstd * ng[1] * siluf_(bfhi(uz)));
    }
    LDS_WAIT(); asm volatile("" ::: "memory");
}

__device__ __forceinline__ void pcache_item(Ctx& F) {
    for (int idx = F.tid; idx < NB * 144 * 16; idx += NWAVES * 64) { const int c = idx & 15, r = (idx >> 4) % 144, b = idx / (144 * 16);
        const int grow = b * RB + (r < 16 ? PADF + r : RB - 128 + (r - 16));
        const v4u wk = *(const v4u*)(F.U + (size_t)grow * NU + C_AK + c * 8), wv = *(const v4u*)(F.U + (size_t)grow * NU + C_AV + c * 8);
        const size_t oo = ((size_t)(b * 144 + r)) * 128 + c * 8;
        *(f32x4*)(F.out + OFF_PK + oo) = (f32x4){bflo(wk.x), bfhi(wk.x), bflo(wk.y), bfhi(wk.y)}; *(f32x4*)(F.out + OFF_PK + oo + 4) = (f32x4){bflo(wk.z), bfhi(wk.z), bflo(wk.w), bfhi(wk.w)};
        *(f32x4*)(F.out + OFF_PV + oo) = (f32x4){bflo(wv.x), bfhi(wv.x), bflo(wv.y), bfhi(wv.y)}; *(f32x4*)(F.out + OFF_PV + oo + 4) = (f32x4){bflo(wv.z), bfhi(wv.z), bflo(wv.w), bfhi(wv.w)}; }
}

__device__ __forceinline__ void p2_other_items(Ctx& F, int first, int stride) {
    constexpr int N_SWP = NB * 64 * 2, N_META = NB * 2, N_MS = DBATCH * 4 / NWAVES, N_SS = DBATCH * 2, N_PC = 1;
    constexpr int NITEMS = N_SWP + N_META + N_MS + N_SS + N_PC;
    for (int it = first; it < NITEMS; it += stride) {
        int r = it;
        if (r < N_SWP) { swa_prompt_item(F, r >> 7, (r >> 1) & 63, r & 1); continue; } r -= N_SWP;
        if (r < N_META) { swa_meta_item(F, r >> 1, r & 1); continue; } r -= N_META;
        if (r < N_MS) { const int wi = r * NWAVES + F.wave; mlstm_sample_item(F, wi >> 2, wi & 3); __syncthreads(); continue; } r -= N_MS;
        if (r < N_SS) { swa_sample_item(F, r >> 1, r & 1); continue; } r -= N_SS;
        pcache_item(F);
    }
}
__device__ __forceinline__ void p2_phase(Ctx& F) {
    constexpr int NCB = 32;
    if (F.G >= 2 * NCB) { if (F.vcu < NCB) chain_block(F, F.vcu >> 2, F.vcu & 3); else p2_other_items(F, F.vcu - NCB, F.G - NCB); }
    else { for (int c = F.vcu; c < NCB; c += F.G) chain_block(F, c >> 2, c & 3); p2_other_items(F, F.vcu, F.G); }
}

constexpr int MO_KS = 288;
constexpr int MO_K = 0, MO_V = 128 * MO_KS, MO_C = 2 * 128 * MO_KS, MO_A = 3 * 128 * MO_KS  , MO_CM = MO_A + 512, MO_B = MO_CM + 512, MO_N = MO_B + 512;
__device__ __forceinline__ void mlstm_out_item(Ctx& F, int bh, int j) {
    const int b = bh >> 2, h = bh & 3, lane = F.lane, tid = F.tid, wave = F.wave;
    const int row0 = b * RB + j * 128;
    ldsp Kt = F.lds + MO_K, Vt = F.lds + MO_V, Ct = F.lds + MO_C;
    LAS float* as_ = (LAS float*)(F.lds + MO_A); LAS float* cms = (LAS float*)(F.lds + MO_CM); LAS float* bs = (LAS float*)(F.lds + MO_B); LAS float* nj = (LAS float*)(F.lds + MO_N);
    for (int pc = tid; pc < 128 * 16; pc += NWAVES * 64) { const int r = pc >> 4, c = pc & 15;
        const bf16* src = F.U + (size_t)(row0 + r) * NU + h * 128 + c * 8;
        *(LAS v4u*)(Kt + r * MO_KS + c * 16) = *(const v4u*)(src + C_MK); *(LAS v4u*)(Vt + r * MO_KS + c * 16) = *(const v4u*)(src + C_MV);
        *(LAS v4u*)(Ct + r * MO_KS + c * 16) = *(const v4u*)(F.CST + ((size_t)(bh * NCH + j) * 128 + r) * 128 + c * 8); }
    if (tid < 128) nj[tid] = F.NST[(size_t)(bh * NCH + j) * 128 + tid];
    const float mj = F.MJ[bh * 66 + j];
    if (wave == 0) {
        const int row = row0 + 2 * lane;
        const float f0 = F.LOGF[row * 4 + h], f1 = F.LOGF[(row + 1) * 4 + h], i0 = F.LOGI[row * 4 + h], i1 = F.LOGI[(row + 1) * 4 + h];
        const float s2 = f0 + f1; float inc = s2;
#pragma unroll
        for (int o = 1; o < 64; o <<= 1) { const float t = __shfl_up(inc, o); if (lane >= o) inc += t; }
        const float b0 = inc - s2 + f0, b1 = inc, a0 = i0 - b0, a1 = i1 - b1;
        float cmx = fmaxf(a0, a1);
#pragma unroll
        for (int o = 1; o < 64; o <<= 1) { const float t = __shfl_up(cmx, o); if (lane >= o) cmx = fmaxf(cmx, t); }
        float prev = __shfl_up(cmx, 1); if (lane == 0) prev = mj; prev = fmaxf(prev, mj);
        const float c0 = fmaxf(prev, a0), c1 = fmaxf(c0, a1);
        bs[2 * lane] = b0; bs[2 * lane + 1] = b1; as_[2 * lane] = a0; as_[2 * lane + 1] = a1; cms[2 * lane] = c0; cms[2 * lane + 1] = c1;
    }
    __syncthreads();
    const int g4 = lane >> 4, r16 = lane & 15, q = r16 >> 2, p = r16 & 3;
    const int tq = 16 * wave + r16; const size_t qrow = (size_t)row0 + tq;
    bf16x8 qf[4];
#pragma unroll
    for (int ks = 0; ks < 4; ++ks) qf[ks] = *(const bf16x8*)(F.U + qrow * NU + C_MQ + h * 128 + 32 * ks + 8 * g4);
    const float cm_t = cms[tq], b_t = bs[tq];
    f32x4 O1[8], O2[8];
#pragma unroll
    for (int d = 0; d < 8; ++d) { O1[d] = (f32x4){0.f, 0.f, 0.f, 0.f}; O2[d] = (f32x4){0.f, 0.f, 0.f, 0.f}; }
    float den = 0.f;
#pragma unroll 1
    for (int kp = 0; kp <= (wave >> 1); ++kp) {
        f32x4 P[2];
#pragma unroll
        for (int hf = 0; hf < 2; ++hf) { const int kt = 2 * kp + hf; f32x4 s = {0.f, 0.f, 0.f, 0.f};
            if (kt <= wave) {
#pragma unroll
                for (int ks = 0; ks < 4; ++ks) { const bf16x8 a = *(const LAS bf16x8*)(Kt + (16 * kt + r16) * MO_KS + (32 * ks + 8 * g4) * 2); s = mfma16(a, qf[ks], s); }
                const f32x4 a4 = *(const LAS f32x4*)(as_ + 16 * kt + 4 * g4);
#pragma unroll
                for (int r = 0; r < 4; ++r) { const bool vis = (kt < wave) || (4 * g4 + r <= r16); const float pv = vis ? s[r] * __expf(a4[r] - cm_t) : 0.f; s[r] = pv; den += pv; }
            }
            P[hf] = s; }
        const bf16x8 pb = packp(P[0], P[1]);
        const int ra = 32 * kp + 4 * g4 + q, rb = ra + 16;
#pragma unroll
        for (int d = 0; d < 8; ++d) { const s16x4 lo = trr(Vt + ra * MO_KS + (16 * d + 4 * p) * 2), hi = trr(Vt + rb * MO_KS + (16 * d + 4 * p) * 2);
            O1[d] = mfma16(cat8(lo, hi), pb, O1[d]); }
    }
    den += __shfl_xor(den, 16); den += __shfl_xor(den, 32);
#pragma unroll
    for (int d = 0; d < 8; ++d)
#pragma unroll
        for (int ks = 0; ks < 4; ++ks) { const bf16x8 a = *(const LAS bf16x8*)(Ct + (16 * d + r16) * MO_KS + (32 * ks + 8 * g4) * 2); O2[d] = mfma16(a, qf[ks], O2[d]); }
    float qn = 0.f;
#pragma unroll
    for (int ks = 0; ks < 4; ++ks) { const f32x4 n0 = *(const LAS f32x4*)(nj + 32 * ks + 8 * g4), n1 = *(const LAS f32x4*)(nj + 32 * ks + 8 * g4 + 4);
        qn += bf1(qf[ks][0]) * n0[0] + bf1(qf[ks][1]) * n0[1] + bf1(qf[ks][2]) * n0[2] + bf1(qf[ks][3]) * n0[3] + bf1(qf[ks][4]) * n1[0] + bf1(qf[ks][5]) * n1[1] + bf1(qf[ks][6]) * n1[2] + bf1(qf[ks][7]) * n1[3]; }
    qn += __shfl_xor(qn, 16); qn += __shfl_xor(qn, 32);
    const float sint = __expf(mj - cm_t), mt = b_t + cm_t;
    const float inv = 1.0f / fmaxf(fabsf(den + sint * qn), __expf(-mt));
    float hs = 0.f;
#pragma unroll
    for (int d = 0; d < 8; ++d) { const v2u o = *(const v2u*)(F.U + qrow * NU + C_MO + h * 128 + 16 * d + 4 * g4);
        f32x4 hv = (O1[d] + O2[d] * sint) * inv;
        hv[0] *= sigmoidf_(bflo(o.x)); hv[1] *= sigmoidf_(bfhi(o.x)); hv[2] *= sigmoidf_(bflo(o.y)); hv[3] *= sigmoidf_(bfhi(o.y));
        O1[d] = hv; hs += (hv[0] + hv[1]) + (hv[2] + hv[3]); }
    hs += __shfl_xor(hs, 16); hs += __shfl_xor(hs, 32);
    const float mean = hs * (1.f / 128.f); float vs = 0.f;
#pragma unroll
    for (int d = 0; d < 8; ++d) { O1[d] = O1[d] - mean; vs += (O1[d][0] * O1[d][0] + O1[d][1] * O1[d][1]) + (O1[d][2] * O1[d][2] + O1[d][3] * O1[d][3]); }
    vs += __shfl_xor(vs, 16); vs += __shfl_xor(vs, 32);
    const float rstd = rsqrtf(vs * (1.f / 128.f) + LN_EPS);
#pragma unroll
    for (int d = 0; d < 8; ++d) { const int dv = 16 * d + 4 * g4; const v2u z = *(const v2u*)(F.U + qrow * NU + C_MZ + h * 128 + dv);
        const f32x4 ng = *(const f32x4*)(F.norm_g + h * 128 + dv);
        v2u w; w.x = pk2(O1[d][0] * rstd * ng[0] * siluf_(bflo(z.x)), O1[d][1] * rstd * ng[1] * siluf_(bfhi(z.x)));
        w.y = pk2(O1[d][2] * rstd * ng[2] * siluf_(bflo(z.y)), O1[d][3] * rstd * ng[3] * siluf_(bfhi(z.y)));
        *(v2u*)(F.Y + qrow * D + h * 128 + dv) = w; }
    __syncthreads();
}
__device__ __forceinline__ void p3_phase(Ctx& F) {
    for (int it = F.vcu; it < 8 * NCH; it += F.G) mlstm_out_item(F, it / NCH, it % NCH);
}

__device__ __forceinline__ void p5_phase(Ctx& F) {
    const int gw = F.vcu * NWAVES + F.wave, NGW = F.G * NWAVES;
    f32x4 gg[4], bb[4];
#pragma unroll
    for (int j = 0; j < 4; ++j) { gg[j] = ((const f32x4*)F.ln_g)[F.lane + 64 * j]; bb[j] = ((const f32x4*)F.ln_b)[F.lane + 64 * j]; }
    for (int row = gw; row < M; row += NGW) {
        float* dst;
        if (row < SROW0) { const int b = row / RB, r = row - b * RB; if (r < PADF + NMETA) continue; dst = F.out + OFF_YP + ((size_t)b * SEQ + (r - PADF - NMETA)) * D; }
        else dst = F.out + OFF_YS + (size_t)(row - SROW0) * D;
        const f32x4* xr = (const f32x4*)(F.MIX + (size_t)row * D) + F.lane;
        f32x4 v[4]; float s = 0.f;
#pragma unroll
        for (int j = 0; j < 4; ++j) { v[j] = xr[64 * j]; s += (v[j].x + v[j].y) + (v[j].z + v[j].w); }
        const float mean = wave_sum(s) * (1.f / D); float s2 = 0.f;
#pragma unroll
        for (int j = 0; j < 4; ++j) { v[j] = v[j] - mean; s2 += (v[j].x * v[j].x + v[j].y * v[j].y) + (v[j].z * v[j].z + v[j].w * v[j].w); }
        const float rstd = 1.f / sqrtf(wave_sum(s2) * (1.f / D) + LN_EPS);
#pragma unroll
        for (int j = 0; j < 4; ++j) ((f32x4*)dst)[F.lane + 64 * j] = v[j] * rstd * gg[j] + bb[j];
    }
}

constexpr int N_PHASES = 6;
struct Args { const float* in[17]; float* out; unsigned char* ws; int ph_lo, ph_hi, li, pad; };
__global__ void __launch_bounds__(NWAVES * 64, 2) mk_fwd(Args args) {
    extern __shared__ __attribute__((aligned(16))) unsigned char lds_raw[];
    Ctx F;
    F.lds = (ldsp)lds_raw;
    F.tid = threadIdx.x; F.lane = F.tid & 63; F.wave = __builtin_amdgcn_readfirstlane(F.tid >> 6);
    F.G = gridDim.x; { const int bx = blockIdx.x; F.vcu = (F.G % 8 == 0) ? (bx % 8) * (F.G / 8) + bx / 8 : bx; }
    unsigned char* ws = args.ws;
    F.x_prompt = args.in[0]; F.x_sample = args.in[1]; F.cache_k = args.in[2]; F.cache_v = args.in[3]; F.st_c = args.in[4]; F.st_n = args.in[5]; F.st_m = args.in[6];
    F.meta = args.in[7]; F.ln0_g = args.in[8]; F.ln0_b = args.in[9]; F.w_in = args.in[10]; F.b_in = args.in[11]; F.sinks = args.in[12]; F.norm_g = args.in[13];
    F.w_out = args.in[14]; F.ln_g = args.in[15]; F.ln_b = args.in[16]; F.out = args.out;
    F.WTIN = (bf16*)(ws + WS_WTIN); F.WTOUT = (bf16*)(ws + WS_WTOUT); F.HP = (bf16*)(ws + WS_HP); F.U = (bf16*)(ws + WS_U); F.CST = (bf16*)(ws + WS_CST); F.Y = (bf16*)(ws + WS_Y);
    F.LOGI = (float*)(ws + WS_LOGI); F.LOGF = (float*)(ws + WS_LOGF); F.MJ = (float*)(ws + WS_MJ); F.NST = (float*)(ws + WS_NST); F.MIX = (float*)(ws + WS_MIX);
    for (int u = F.tid; u < (LDS_BYTES - LDSCTL_OFF) / 4; u += NWAVES * 64) ((LAS unsigned*)(F.lds + LDSCTL_OFF))[u] = 0u;
    __syncthreads();
    volatile LAS unsigned* MISC = (volatile LAS unsigned*)(F.lds + MISC_OFF);
    const int lo = args.ph_lo, hi = args.ph_hi;
    XcdBarrier bar; bar.bar = (unsigned*)(ws + WS_CTL) + CW_BAR + args.li * XCD_BAR_WORDS; bar.x = 0; bar.st = nullptr;
    if (hi - lo > 1) bar = xcd_barrier_post((unsigned*)(ws + WS_CTL) + CW_BAR + args.li * XCD_BAR_WORDS, MISC + 8);
#define IN(k) (lo <= (k) && (k) < hi)
#define SEAM(k) do { if (IN(k) && IN((k) + 1)) xcd_barrier(bar); } while (0)
    if (IN(0)) { p0_prologue(F); SEAM(0); }
    if (IN(1)) {
        pg8::Gemm g{F.HP, F.WTIN, M, NU, D}; pg8::StaticOrder S; S.init(M, NU, F.G, (int)blockIdx.x);
        pg8::EpiU E{F.U, F.b_in};
        pg8::gemm_phase<pg8::EpiU, pg8::StaticOrder, true, true>(F.lds, g, S, E);
        SEAM(1);
    }
    if (IN(2)) { p2_phase(F); SEAM(2); }
    if (IN(3)) { p3_phase(F); SEAM(3); }
    if (IN(4)) {
        pg8::Gemm g{F.Y, F.WTOUT, M, D, D}; pg8::StaticOrder S; S.init(M, D, F.G, (int)blockIdx.x);
        pg8::EpiMix E{F.MIX, F.HP, DN_ALPHA};
        pg8::gemm_phase<pg8::EpiMix, pg8::StaticOrder, true, true>(F.lds, g, S, E);
        SEAM(4);
    }
    if (IN(5)) p5_phase(F);
#undef IN
#undef SEAM
}

#ifndef MK_N_LAUNCHES
#define MK_N_LAUNCHES 6
#endif
extern "C" void kernel_launch(void* const* d_in, const int* in_sizes, int n_in, void* d_out, int out_size, void* d_ws, size_t ws_size, hipStream_t stream) {
    static int grid = 0;
    if (grid == 0) {
        if (n_in != 17 || (size_t)out_size != OUT_TOTAL || ws_size < WS_END) { fprintf(stderr, "kernel_launch: unexpected shapes (n_in %d, out %d, ws %zu)\n", n_in, out_size, ws_size); grid = -1; return; }
        int dev = 0, cus = 0, per_cu = 0;
        if (hipGetDevice(&dev) != hipSuccess || hipDeviceGetAttribute(&cus, hipDeviceAttributeMultiprocessorCount, dev) != hipSuccess) { grid = -1; return; }
        if (hipFuncSetAttribute((const void*)mk_fwd, hipFuncAttributeMaxDynamicSharedMemorySize, LDS_BYTES) != hipSuccess) { fprintf(stderr, "kernel_launch: hipFuncSetAttribute failed\n"); grid = -1; return; }
        if (hipOccupancyMaxActiveBlocksPerMultiprocessor(&per_cu, (const void*)mk_fwd, NWAVES * 64, LDS_BYTES) != hipSuccess || per_cu < 1)
            fprintf(stderr, "kernel_launch: note: occupancy query reports %d workgroups per CU\n", per_cu);
        (void)hipGetLastError();
        grid = cus;
    }
    if (grid < 0) return;
    if (hipMemsetAsync((char*)d_ws + WS_CTL, 0, CTL_ZERO_BYTES, stream) != hipSuccess) return;
    Args a{};
    for (int i = 0; i < 17; ++i) a.in[i] = (const float*)d_in[i];
    a.out = (float*)d_out; a.ws = (unsigned char*)d_ws;
    constexpr int NL = MK_N_LAUNCHES;
    for (int li = 0; li < NL; ++li) {
        a.ph_lo = (NL == 1) ? 0 : li; a.ph_hi = (NL == 1) ? N_PHASES : li + 1; a.li = (NL == 1) ? 0 : 0;
        hipLaunchKernelGGL(mk_fwd, dim3(grid), dim3(NWAVES * 64), LDS_BYTES, stream, a);
        if (hipPeekAtLastError() != hipSuccess) { fprintf(stderr, "kernel_launch: launch %d failed\n", li); break; }
    }
}
```
